# Optimizing an MI355X kernel written in HIP

```python
import math
import jax, jax.numpy as jnp
from jax import lax
import numpy as np

D_MODEL = 1024
BATCH = 8
SEQ = 2048
DEPTH = 1
DEC_BATCH = 128
DEC_SEQ = 1
PAST_LEN = 16384
PAGE_SIZE = 128

ATTN_HEADS = 8
ATTN_KV_HEADS = 2
ATTN_HEAD_DIM = 64
WINDOW = 128
ATTN_BLOCK = 128
REL_BUCKETS = 32
REL_MAX_DIST = 128
RET_HEADS = 4
RET_DK = 128
RET_DV = 128
RET_CHUNK = 128
ROPE_BASE = 10000.0
D_FF = 2816
LN_EPS = 1e-5
GN_EPS = 1e-6
ALPHA = (2.0 * DEPTH) ** 0.25
BETA = (8.0 * DEPTH) ** -0.25

ATTN_Q = ATTN_HEADS * ATTN_HEAD_DIM
ATTN_KV = ATTN_KV_HEADS * ATTN_HEAD_DIM
RET_QK = RET_HEADS * RET_DK
RET_V = RET_HEADS * RET_DV
IN_COLS = ATTN_Q + 2 * ATTN_KV + 2 * RET_QK + 2 * RET_V + 2 * D_MODEL

kernel_name = "hybrid_swa_retention_macaron_step"


def layer_norm(x, g, b):
    xf = x.astype(jnp.float32)
    mu = xf.mean(-1, keepdims=True)
    var = jnp.square(xf - mu).mean(-1, keepdims=True)
    return ((xf - mu) * lax.rsqrt(var + LN_EPS) * g.astype(jnp.float32) + b.astype(jnp.float32)).astype(x.dtype)


def swiglu(x, w_up, w_down):
    gate, up = jnp.split(x @ w_up, 2, axis=-1)
    return (jax.nn.silu(gate) * up) @ w_down


def rel_bucket(dist):
    n = jnp.maximum(dist, 0)
    max_exact = REL_BUCKETS // 2
    ratio = jnp.maximum(n, 1).astype(jnp.float32) / max_exact
    large = max_exact + (jnp.log(jnp.maximum(ratio, 1.0)) / math.log(REL_MAX_DIST / max_exact)
                         * (REL_BUCKETS - max_exact)).astype(jnp.int32)
    large = jnp.minimum(large, REL_BUCKETS - 1)
    return jnp.where(n < max_exact, n, large)


def rotary(x, pos):
    half = x.shape[-1] // 2
    inv = ROPE_BASE ** (-jnp.arange(half, dtype=jnp.float32) / half)
    ang = pos.astype(jnp.float32)[:, None] * inv[None, :]
    cos = jnp.cos(ang)[None, :, None, :]
    sin = jnp.sin(ang)[None, :, None, :]
    xf = x.astype(jnp.float32)
    x1, x2 = xf[..., :half], xf[..., half:]
    return jnp.concatenate([x1 * cos - x2 * sin, x2 * cos + x1 * sin], axis=-1).astype(x.dtype)


def project(x, w_in, pos):
    B, L, _ = x.shape
    sizes = (ATTN_Q, ATTN_KV, ATTN_KV, RET_QK, RET_QK, RET_V, RET_V, D_MODEL, D_MODEL)
    idx = [int(i) for i in np.cumsum(sizes)[:-1]]
    qa, ka, va, qr, kr, vr, gr, ga, gb = jnp.split(x @ w_in, idx, axis=-1)
    qa = qa.reshape(B, L, ATTN_HEADS, ATTN_HEAD_DIM)
    ka = ka.reshape(B, L, ATTN_KV_HEADS, ATTN_HEAD_DIM)
    va = va.reshape(B, L, ATTN_KV_HEADS, ATTN_HEAD_DIM)
    qr = rotary(qr.reshape(B, L, RET_HEADS, RET_DK), pos)
    kr = rotary(kr.reshape(B, L, RET_HEADS, RET_DK), pos) * (RET_DK ** -0.5)
    vr = vr.reshape(B, L, RET_HEADS, RET_DV)
    return qa, ka, va, qr, kr, vr, gr, ga, gb


def window_attention(q, k, v, q_pos, k_pos, sinks, rel_bias):
    B, NB, Lq, H, hd = q.shape
    Lk = k.shape[2]
    G = H // ATTN_KV_HEADS
    qg = q.reshape(B, NB, Lq, ATTN_KV_HEADS, G, hd)
    s = jnp.einsum('bnqhgd,bnshd->bnhgqs', qg, k).astype(jnp.float32) * (hd ** -0.5)
    dist = q_pos[:, :, None] - k_pos[:, None, :]
    allowed = (dist >= 0) & (dist < WINDOW) & (k_pos[:, None, :] >= 0)
    bias = rel_bias.astype(jnp.float32)[rel_bucket(dist)]
    bias = bias.transpose(0, 3, 1, 2).reshape(NB, ATTN_KV_HEADS, G, Lq, Lk)
    s = jnp.where(allowed[None, :, None, None], s + bias[None], -jnp.inf)
    sink = sinks.astype(jnp.float32).reshape(ATTN_KV_HEADS, G)[None, None, :, :, None, None]
    m = jnp.maximum(s.max(-1, keepdims=True), sink)
    p = jnp.exp(s - m)
    p = p / (p.sum(-1, keepdims=True) + jnp.exp(sink - m))
    o = jnp.einsum('bnhgqs,bnshd->bnqhgd', p.astype(v.dtype), v)
    return o.reshape(B, NB, Lq, H * hd)


def retention_chunks(q, k, v, s0):
    C = q.shape[2]
    lg = jnp.log1p(-(2.0 ** (-5.0 - jnp.arange(RET_HEADS, dtype=jnp.float32))))
    i = jnp.arange(C, dtype=jnp.float32)
    diff = i[:, None] - i[None, :]
    dmask = jnp.where(diff[None] >= 0, jnp.exp(jnp.maximum(diff, 0.0)[None] * lg[:, None, None]), 0.0)
    scores = jnp.einsum('bnihd,bnjhd->bnhij', q, k) * dmask
    inner = jnp.einsum('bnhij,bnjhe->bnihe', scores, v)
    k_tail = k * jnp.exp((C - 1 - i)[:, None] * lg[None, :])[None, None, :, :, None]
    u = jnp.einsum('bnjhd,bnjhe->nbhde', k_tail, v)
    chunk_decay = jnp.exp(C * lg)[None, :, None, None]

    def step(s, u_n):
        return chunk_decay * s + u_n, s

    s_final, s_prev = lax.scan(step, s0, u)
    q_dec = q * jnp.exp((i + 1)[:, None] * lg[None, :])[None, None, :, :, None]
    cross = jnp.einsum('bnihd,nbhde->bnihe', q_dec, s_prev)
    return inner + cross, s_final


def head_group_norm(o):
    mu = o.mean(-1, keepdims=True)
    var = jnp.square(o - mu).mean(-1, keepdims=True)
    return (o - mu) * lax.rsqrt(var + GN_EPS)


def merge_branches(o_attn, o_ret, gr, ga, gb, w_attn_out, w_ret_out, w_o):
    B, L, _ = o_attn.shape
    r = head_group_norm(o_ret).reshape(B, L, RET_V).astype(gr.dtype) * jax.nn.silu(gr)
    merged = jax.nn.sigmoid(ga) * (o_attn @ w_attn_out) + jax.nn.sigmoid(gb) * (r @ w_ret_out)
    return merged @ w_o


def prompt_mixers(x, w_in, sinks, rel_bias, w_attn_out, w_ret_out, w_o, state_dtype):
    B, S, _ = x.shape
    pos = jnp.arange(S, dtype=jnp.int32)
    qa, ka, va, qr, kr, vr, gr, ga, gb = project(x, w_in, pos)
    nb = S // ATTN_BLOCK

    def band(t):
        tp = jnp.pad(t, ((0, 0), (ATTN_BLOCK, 0), (0, 0), (0, 0)))
        tp = tp.reshape(B, nb + 1, ATTN_BLOCK, ATTN_KV_HEADS, ATTN_HEAD_DIM)
        return jnp.concatenate([tp[:, :-1], tp[:, 1:]], axis=2)

    q_pos = pos.reshape(nb, ATTN_BLOCK)
    k_pos = jnp.concatenate([q_pos - ATTN_BLOCK, q_pos], axis=1)
    q_blk = qa.reshape(B, nb, ATTN_BLOCK, ATTN_HEADS, ATTN_HEAD_DIM)
    o_attn = window_attention(q_blk, band(ka), band(va), q_pos, k_pos, sinks, rel_bias).reshape(B, S, ATTN_Q)
    nc = S // RET_CHUNK

    def chunk(t):
        return t.astype(jnp.float32).reshape(B, nc, RET_CHUNK, RET_HEADS, t.shape[-1])

    s0 = jnp.zeros((B, RET_HEADS, RET_DK, RET_DV), jnp.float32)
    o_ret, s_fin = retention_chunks(chunk(qr), chunk(kr), chunk(vr), s0)
    o_ret = o_ret.reshape(B, S, RET_HEADS, RET_DV)
    y = merge_branches(o_attn, o_ret, gr, ga, gb, w_attn_out, w_ret_out, w_o)
    return y, ka[:, -WINDOW:], va[:, -WINDOW:], s_fin.astype(state_dtype)


def sample_mixers(x, k_buf, v_buf, s_prev, w_in, sinks, rel_bias, w_attn_out, w_ret_out, w_o):
    B, L, _ = x.shape
    pos = PAST_LEN + jnp.arange(L, dtype=jnp.int32)
    qa, ka, va, qr, kr, vr, gr, ga, gb = project(x, w_in, pos)
    w = k_buf.shape[1]
    k_all = jnp.concatenate([k_buf.astype(ka.dtype), ka], axis=1)
    v_all = jnp.concatenate([v_buf.astype(va.dtype), va], axis=1)
    k_pos = jnp.concatenate([PAST_LEN - w + jnp.arange(w, dtype=jnp.int32), pos])
    o_attn = window_attention(qa[:, None], k_all[:, None], v_all[:, None], pos[None], k_pos[None],
                              sinks, rel_bias).reshape(B, L, ATTN_Q)

    def one_chunk(t):
        return t.astype(jnp.float32)[:, None]

    o_ret, s_new = retention_chunks(one_chunk(qr), one_chunk(kr), one_chunk(vr), s_prev.astype(jnp.float32))
    o_ret = o_ret.reshape(B, L, RET_HEADS, RET_DV)
    y = merge_branches(o_attn, o_ret, gr, ga, gb, w_attn_out, w_ret_out, w_o)
    return y, k_all[:, -WINDOW:], v_all[:, -WINDOW:], s_new.astype(s_prev.dtype)


def setup_inputs(seed: int = 0) -> dict:
    key = jax.random.key(seed)
    ks = jax.random.split(key, 24)
    f32 = jnp.float32

    def nrm(k, shape, scale):
        return jax.random.normal(k, shape, f32) * scale

    return {
        "x_prompt": nrm(ks[0], (BATCH, SEQ, D_MODEL), 1.0),
        "x_sample": nrm(ks[1], (DEC_BATCH, DEC_SEQ, D_MODEL), 1.0),
        "cache_k_win": nrm(ks[2], (DEPTH, DEC_BATCH, WINDOW, ATTN_KV_HEADS, ATTN_HEAD_DIM), 1.0),
        "cache_v_win": nrm(ks[3], (DEPTH, DEC_BATCH, WINDOW, ATTN_KV_HEADS, ATTN_HEAD_DIM), 1.0),
        "state_ret": nrm(ks[4], (DEPTH, DEC_BATCH, RET_HEADS, RET_DK, RET_DV), 0.3),
        "rel_bias": nrm(ks[5], (REL_BUCKETS, ATTN_HEADS), 0.5),
        "w_in": nrm(ks[6], (DEPTH, D_MODEL, IN_COLS), D_MODEL ** -0.5),
        "attn_sinks": nrm(ks[7], (DEPTH, ATTN_HEADS), 0.5),
        "w_attn_out": nrm(ks[8], (DEPTH, ATTN_Q, D_MODEL), BETA * ATTN_Q ** -0.5),
        "w_ret_out": nrm(ks[9], (DEPTH, RET_V, D_MODEL), BETA * RET_V ** -0.5),
        "w_o": nrm(ks[10], (DEPTH, D_MODEL, D_MODEL), BETA * D_MODEL ** -0.5),
        "ffn1_w_up": nrm(ks[11], (DEPTH, D_MODEL, 2 * D_FF), D_MODEL ** -0.5),
        "ffn1_w_down": nrm(ks[12], (DEPTH, D_FF, D_MODEL), BETA * D_FF ** -0.5),
        "ffn2_w_up": nrm(ks[13], (DEPTH, D_MODEL, 2 * D_FF), D_MODEL ** -0.5),
        "ffn2_w_down": nrm(ks[14], (DEPTH, D_FF, D_MODEL), BETA * D_FF ** -0.5),
        "ln1_g": 1.0 + nrm(ks[15], (DEPTH, D_MODEL), 0.01),
        "ln1_b": nrm(ks[16], (DEPTH, D_MODEL), 0.01),
        "ln2_g": 1.0 + nrm(ks[17], (DEPTH, D_MODEL), 0.01),
        "ln2_b": nrm(ks[18], (DEPTH, D_MODEL), 0.01),
        "ln3_g": 1.0 + nrm(ks[19], (DEPTH, D_MODEL), 0.01),
        "ln3_b": nrm(ks[20], (DEPTH, D_MODEL), 0.01),
    }


def reference(x_prompt, x_sample, cache_k_win, cache_v_win, state_ret, rel_bias, w_in, attn_sinks,
              w_attn_out, w_ret_out, w_o, ffn1_w_up, ffn1_w_down, ffn2_w_up, ffn2_w_down,
              ln1_g, ln1_b, ln2_g, ln2_b, ln3_g, ln3_b):
    hp, hs = x_prompt, x_sample
    kp_l, vp_l, sp_l, ks_l, vs_l, ss_l = [], [], [], [], [], []
    for l in range(DEPTH):
        hp = layer_norm(ALPHA * hp + 0.5 * swiglu(hp, ffn1_w_up[l], ffn1_w_down[l]), ln1_g[l], ln1_b[l])
        hs = layer_norm(ALPHA * hs + 0.5 * swiglu(hs, ffn1_w_up[l], ffn1_w_down[l]), ln1_g[l], ln1_b[l])
        mp, kp, vp, sp = prompt_mixers(hp, w_in[l], attn_sinks[l], rel_bias, w_attn_out[l], w_ret_out[l], w_o[l],
                                       state_ret.dtype)
        ms, kbs, vbs, ss = sample_mixers(hs, cache_k_win[l], cache_v_win[l], state_ret[l], w_in[l], attn_sinks[l],
                                         rel_bias, w_attn_out[l], w_ret_out[l], w_o[l])
        hp = layer_norm(ALPHA * hp + mp, ln2_g[l], ln2_b[l])
        hs = layer_norm(ALPHA * hs + ms, ln2_g[l], ln2_b[l])
        hp = layer_norm(ALPHA * hp + 0.5 * swiglu(hp, ffn2_w_up[l], ffn2_w_down[l]), ln3_g[l], ln3_b[l])
        hs = layer_norm(ALPHA * hs + 0.5 * swiglu(hs, ffn2_w_up[l], ffn2_w_down[l]), ln3_g[l], ln3_b[l])
        kp_l.append(kp); vp_l.append(vp); sp_l.append(sp)
        ks_l.append(kbs); vs_l.append(vbs); ss_l.append(ss)
    k_win_prompt = jnp.stack(kp_l)
    v_win_prompt = jnp.stack(vp_l)
    state_ret_prompt = jnp.stack(sp_l)
    k_win_sample = jnp.stack(ks_l)
    v_win_sample = jnp.stack(vs_l)
    state_ret_sample = jnp.stack(ss_l)
    return (hp, hs, k_win_prompt, v_win_prompt, state_ret_prompt, k_win_sample, v_win_sample, state_ret_sample)
```

```cpp
#include <hip/hip_runtime.h>
#include <hip/hip_cooperative_groups.h>
#include <cstdio>
#include <cstdint>
namespace cg = cooperative_groups;

#ifndef MK_N_LAUNCHES
#define MK_N_LAUNCHES 13
#endif

#define LAS __attribute__((address_space(3)))
typedef unsigned short bf16_t;
typedef short bf16x8 __attribute__((ext_vector_type(8)));
typedef short s16x4 __attribute__((ext_vector_type(4)));
typedef float f32x4 __attribute__((ext_vector_type(4)));
typedef float f32x2 __attribute__((ext_vector_type(2)));
typedef unsigned u32x4 __attribute__((ext_vector_type(4)));
typedef unsigned u32x2 __attribute__((ext_vector_type(2)));
typedef unsigned char uchar;

constexpr int DM = 1024, SEQ = 2048, MPROMPT = 16384, MSAMP = 128, MTOT = MPROMPT + MSAMP, MPAD = 16640;
constexpr int DFF = 2816, NUP = 5632, NIN = 4864, NPJ = 2816, NGT = 2048;
constexpr int C_QA = 0, C_KA = 512, C_VA = 640, C_QR = 768, C_KR = 1280, C_VR = 1792, C_GR = 2304;
constexpr float LN_EPS = 1e-5f, GN_EPS = 1e-6f, ALPHA = 1.189207115002721f;
constexpr size_t O_YP = 0, O_YS = 16777216, O_KWP = 16908288, O_VWP = 17039360, O_SP = 17170432, O_KWS = 17694720, O_VWS = 19791872, O_SS = 21889024;
constexpr size_t MiB = 1u << 20;
constexpr size_t WS_CTL = 0, CTL_BYTES = 1 * MiB;
constexpr size_t CTL_ST1 = 65536, CTL_ST2 = 262144, CTL_C1IN = 524288, CTL_C2IN = 557056, CTL_C1UP = 589824, CTL_C2UP = 622592;
constexpr size_t WS_ROPE = 1 * MiB;
constexpr size_t WS_WUP1 = 4 * MiB, WS_WDN1 = 15 * MiB, WS_WIN = 21 * MiB, WS_WAO = 31 * MiB, WS_WRO = 32 * MiB, WS_WO = 33 * MiB, WS_WUP2 = 35 * MiB, WS_WDN2 = 46 * MiB;
constexpr size_t WS_XB = 52 * MiB;
constexpr size_t WS_Z1 = 85 * MiB, WS_Z2 = 118 * MiB;
constexpr size_t WS_BIG = 151 * MiB;
constexpr size_t WS_END = 241 * MiB;
static_assert(WS_BIG + (size_t)MPAD * 2816 * 2 <= WS_END, "ws map");
constexpr size_t OUT_U = 0, OUT_GB = 0;

__device__ __forceinline__ unsigned f2bf(float f) { unsigned u = __builtin_bit_cast(unsigned, f); return (u + 0x7fffu + ((u >> 16) & 1u)) >> 16; }
__device__ __forceinline__ unsigned pk2(float lo, float hi) { return f2bf(lo) | (f2bf(hi) << 16); }
__device__ __forceinline__ float bflo(unsigned w) { return __uint_as_float(w << 16); }
__device__ __forceinline__ float bfhi(unsigned w) { return __uint_as_float(w & 0xffff0000u); }
__device__ __forceinline__ float bf2f(bf16_t b) { return __uint_as_float((unsigned)b << 16); }
__device__ __forceinline__ void unpack8(u32x4 w, float (&f)[8]) { f[0] = bflo(w.x); f[1] = bfhi(w.x); f[2] = bflo(w.y); f[3] = bfhi(w.y); f[4] = bflo(w.z); f[5] = bfhi(w.z); f[6] = bflo(w.w); f[7] = bfhi(w.w); }
__device__ __forceinline__ u32x4 pack8(const float (&f)[8]) { u32x4 w; w.x = pk2(f[0], f[1]); w.y = pk2(f[2], f[3]); w.z = pk2(f[4], f[5]); w.w = pk2(f[6], f[7]); return w; }
__device__ __forceinline__ float sigmoidf_(float x) { return __builtin_amdgcn_rcpf(1.0f + __expf(-x)); }

namespace pg8 {
constexpr int BM = 256, BK = 64, HALF = 128, HTB = HALF * BK * 2, STAGE_BYTES = 8 * HTB, NXCD = 8, WGM = 8;
__host__ __device__ __forceinline__ int lds_byte(int r, int c) { const int st = (r >> 4) * 2 + (c >> 5), rr = r & 15, cc = c & 31, ob = rr * 64 + cc * 2; return st * 1024 + (ob ^ (((ob >> 9) & 1) << 5)); }
__host__ __device__ __forceinline__ void stage_rc(int b, int& R, int& C) { const int st = b / 1024, sb = b % 1024, swz = sb ^ (((sb >> 9) & 1) << 5); R = (st >> 1) * 16 + swz / 64; C = (st & 1) * 32 + (swz % 64) / 2; }
__host__ __device__ __forceinline__ int perm32(int rho) { const int n = rho >> 4, i = rho & 15; return 8 * (i >> 2) + 4 * n + (i & 3); }

struct Unit { int pm, pn; };
struct Gemm { const bf16_t* A; const bf16_t* Bt; int M, N, K, lda; };

struct StaticOrder {
    int nM, nN, nwg, G, c;
    __host__ __device__ void init(int M, int N, int G_, int c_) { nM = M / BM; nN = N / BM; nwg = nM * nN; G = G_; c = c_; }
    __host__ __device__ bool next(int i, Unit& u) const {
        const long L = (long)i * G + c; if (L >= nwg) return false;
        int wgid = (int)L; { const int q = nwg / NXCD, r = nwg % NXCD, xcd = wgid % NXCD, off = wgid / NXCD; wgid = (xcd < r ? xcd * (q + 1) : r * (q + 1) + (xcd - r) * q) + off; }
        const int nig = WGM * nN, gid = wgid / nig, fm = gid * WGM, gsz = (nM - fm) < WGM ? (nM - fm) : WGM;
        u.pm = fm + ((wgid % nig) % gsz); u.pn = (wgid % nig) / gsz; return true;
    }
    __device__ __forceinline__ void a_ready(const Unit&) const {}
    __device__ __forceinline__ void done(const Unit&) const {}
};

template <class Epi, class Sched, bool ALIGN_EPI = false, bool SP2 = false>
__device__ __forceinline__ void gemm_phase(LAS unsigned char* lds, const Gemm g, const Sched& S, const Epi& E) {
    const int tid = threadIdx.x, wid = __builtin_amdgcn_readfirstlane(tid >> 6), lane = tid & 63, wr = wid >> 2, wc = wid & 3, fr = lane & 15, fq = lane >> 4;
    const int K = g.K, nt = K / BK;
    unsigned voffA[2], voffB[2];
#pragma unroll
    for (int i = 0; i < 2; ++i) { int R, C; stage_rc(tid * 16 + i * 8192, R, C); const int Rb = Epi::PERM ? ((R & ~31) + perm32(R & 31)) : R;
        voffA[i] = (unsigned)(R * g.lda + C) * 2u; voffB[i] = (unsigned)(Rb * K + C) * 2u; }
    const size_t kstep = (size_t)(BK * 2);
    const size_t hstepA = (size_t)HALF * g.lda * 2, hstepB = (size_t)HALF * K * 2;
    const size_t tstepA = 2 * hstepA, tstepB = 2 * hstepB;
    const unsigned ldsw = (unsigned)wid * 1024u;
    const int aoff = lds_byte(wr * 64 + fr, fq * 8), boff = lds_byte(wc * 32 + fr, fq * 8);
#define PG8_SA(b, h) (((b) * 2 + (h)) * HTB)
#define PG8_SB(b, h) ((4 + (b) * 2 + (h)) * HTB)
#define PG8_STAGE(bufoff, gbase, voff) do { _Pragma("unroll") for (int _i = 0; _i < 2; ++_i) \
        __builtin_amdgcn_global_load_lds((const unsigned*)((const char*)(gbase) + (voff)[_i]), (LAS unsigned*)(lds + (bufoff) + ldsw + _i * 8192), 16, 0, 0); } while (0)
#define PG8_LDA(dst, b, h) do { _Pragma("unroll") for (int m = 0; m < 4; ++m) _Pragma("unroll") for (int k = 0; k < 2; ++k) dst[m][k] = *(const LAS bf16x8*)(lds + PG8_SA(b, h) + aoff + m * 2048 + k * 1024); } while (0)
#define PG8_LDB(dst, b, h) do { _Pragma("unroll") for (int n = 0; n < 2; ++n) _Pragma("unroll") for (int k = 0; k < 2; ++k) dst[n][k] = *(const LAS bf16x8*)(lds + PG8_SB(b, h) + boff + n * 2048 + k * 1024); } while (0)
#define PG8_MMA(ai, bj, At, Bt) do { __builtin_amdgcn_s_setprio(1); _Pragma("unroll") for (int m = 0; m < 4; ++m) _Pragma("unroll") for (int n = 0; n < 2; ++n) _Pragma("unroll") for (int k = 0; k < 2; ++k) \
        acc[ai][bj][m][n] = __builtin_amdgcn_mfma_f32_16x16x32_bf16(Bt[n][k], At[m][k], acc[ai][bj][m][n], 0, 0, 0); __builtin_amdgcn_s_setprio(0); } while (0)
#define PG8_WAIT_V(n) asm volatile("s_waitcnt vmcnt(" #n ")" ::: "memory")
#define PG8_WAIT_L(n) asm volatile("s_waitcnt lgkmcnt(" #n ")" ::: "memory")
#define PG8_BAR __builtin_amdgcn_s_barrier()
#define PG8_SCHED __builtin_amdgcn_sched_barrier(0)
    Unit cur, nxt; int ui = 0;
    if (!S.next(0, cur)) return;
    f32x4 acc[2][2][4][2];
#pragma unroll
    for (int a = 0; a < 2; ++a)
#pragma unroll
        for (int b = 0; b < 2; ++b)
#pragma unroll
            for (int m = 0; m < 4; ++m)
#pragma unroll
                for (int n = 0; n < 2; ++n) acc[a][b][m][n] = (f32x4){0.f, 0.f, 0.f, 0.f};
    bf16x8 At[4][2], B0[2][2], B1[2][2];
    const char* cA = (const char*)g.A + (size_t)cur.pm * tstepA; const char* cB = (const char*)g.Bt + (size_t)cur.pn * tstepB;
    S.a_ready(cur);
    if constexpr (SP2) {
        PG8_STAGE(PG8_SB(0, 0), cB, voffB); PG8_STAGE(PG8_SB(0, 1), cB + hstepB, voffB); PG8_STAGE(PG8_SA(0, 0), cA, voffA); PG8_STAGE(PG8_SA(0, 1), cA + hstepA, voffA);
        if (wr == 1) PG8_BAR;
        PG8_WAIT_V(2); PG8_BAR;
        PG8_STAGE(PG8_SB(1, 0), cB + kstep, voffB); PG8_STAGE(PG8_SA(1, 0), cA + kstep, voffA); PG8_STAGE(PG8_SB(1, 1), cB + hstepB + kstep, voffB);
        PG8_WAIT_V(6); PG8_BAR;
    } else {
        PG8_STAGE(PG8_SB(0, 0), cB, voffB); PG8_STAGE(PG8_SA(0, 0), cA, voffA); PG8_STAGE(PG8_SB(0, 1), cB + hstepB, voffB); PG8_STAGE(PG8_SA(0, 1), cA + hstepA, voffA);
        if (wr == 1) PG8_BAR;
        PG8_WAIT_V(4); PG8_BAR;
        PG8_STAGE(PG8_SB(1, 0), cB + kstep, voffB); PG8_STAGE(PG8_SA(1, 0), cA + kstep, voffA); PG8_STAGE(PG8_SB(1, 1), cB + hstepB + kstep, voffB);
        PG8_WAIT_V(6); PG8_BAR;
    }
    for (;;) {
        const bool has_next = S.next(ui + 1, nxt);
        const char* nA = has_next ? (const char*)g.A + (size_t)nxt.pm * tstepA : cA; const char* nB = has_next ? (const char*)g.Bt + (size_t)nxt.pn * tstepB : cB;
        for (int t = 0; t < nt; t += 2) {
            const bool last = (t == nt - 2);
            const char* a1 = cA + (size_t)(t + 1) * kstep;
            const char* a2 = last ? nA : cA + (size_t)(t + 2) * kstep; const char* b2 = last ? nB : cB + (size_t)(t + 2) * kstep;
            const char* a3 = a2 + kstep; const char* b3 = b2 + kstep;
            if (last && has_next) S.a_ready(nxt);
            if constexpr (SP2) {
            PG8_LDB(B0, 0, 0); PG8_LDB(B1, 0, 1); PG8_SCHED; PG8_LDA(At, 0, 0); PG8_STAGE(PG8_SA(1, 1), a1 + hstepA, voffA);
            PG8_WAIT_V(8); PG8_WAIT_L(0); PG8_BAR; PG8_MMA(0, 0, At, B0); PG8_MMA(0, 1, At, B1); PG8_BAR; PG8_SCHED;
            PG8_LDA(At, 0, 1); PG8_STAGE(PG8_SB(0, 0), b2, voffB); PG8_STAGE(PG8_SB(0, 1), b2 + hstepB, voffB); PG8_STAGE(PG8_SA(0, 0), a2, voffA);
            PG8_WAIT_V(8); PG8_WAIT_L(0); PG8_BAR; PG8_MMA(1, 0, At, B0); PG8_MMA(1, 1, At, B1); PG8_BAR; PG8_SCHED;
            PG8_LDB(B0, 1, 0); PG8_LDB(B1, 1, 1); PG8_SCHED; PG8_LDA(At, 1, 0); PG8_STAGE(PG8_SA(0, 1), a2 + hstepA, voffA);
            PG8_WAIT_V(8); PG8_WAIT_L(0); PG8_BAR; PG8_MMA(0, 0, At, B0); PG8_MMA(0, 1, At, B1); PG8_BAR; PG8_SCHED;
            PG8_LDA(At, 1, 1); PG8_STAGE(PG8_SB(1, 0), b3, voffB); PG8_STAGE(PG8_SB(1, 1), b3 + hstepB, voffB); PG8_STAGE(PG8_SA(1, 0), a3, voffA);
            PG8_WAIT_V(8); PG8_WAIT_L(0); PG8_BAR; PG8_MMA(1, 0, At, B0); PG8_MMA(1, 1, At, B1); PG8_BAR; PG8_SCHED;
            } else {
            PG8_LDB(B0, 0, 0); PG8_SCHED; PG8_LDA(At, 0, 0); PG8_STAGE(PG8_SA(1, 1), a1 + hstepA, voffA);
            PG8_WAIT_L(8); PG8_BAR; PG8_WAIT_L(0); PG8_MMA(0, 0, At, B0); PG8_BAR; PG8_SCHED;
            PG8_LDB(B1, 0, 1); PG8_STAGE(PG8_SB(0, 0), b2, voffB);
            PG8_BAR; PG8_WAIT_L(0); PG8_MMA(0, 1, At, B1); PG8_BAR;
            PG8_LDA(At, 0, 1); PG8_STAGE(PG8_SA(0, 0), a2, voffA);
            PG8_BAR; PG8_WAIT_L(0); PG8_MMA(1, 0, At, B0); PG8_BAR; PG8_SCHED;
            PG8_STAGE(PG8_SB(0, 1), b2 + hstepB, voffB);
            PG8_WAIT_V(6); PG8_BAR; PG8_MMA(1, 1, At, B1); PG8_BAR;
            PG8_LDB(B0, 1, 0); PG8_SCHED; PG8_LDA(At, 1, 0); PG8_STAGE(PG8_SA(0, 1), a2 + hstepA, voffA);
            PG8_WAIT_L(8); PG8_BAR; PG8_WAIT_L(0); PG8_MMA(0, 0, At, B0); PG8_BAR; PG8_SCHED;
            PG8_LDB(B1, 1, 1); PG8_STAGE(PG8_SB(1, 0), b3, voffB);
            PG8_BAR; PG8_WAIT_L(0); PG8_MMA(0, 1, At, B1); PG8_BAR;
            PG8_LDA(At, 1, 1); PG8_STAGE(PG8_SA(1, 0), a3, voffA);
            PG8_BAR; PG8_WAIT_L(0); PG8_MMA(1, 0, At, B0); PG8_BAR; PG8_SCHED;
            PG8_STAGE(PG8_SB(1, 1), b3 + hstepB, voffB);
            PG8_WAIT_V(6); PG8_BAR; PG8_MMA(1, 1, At, B1); PG8_BAR;
            }
        }
        if constexpr (ALIGN_EPI) { if (wr == 0) PG8_BAR; }
        E(acc, cur, wr, wc, fr, fq); S.done(cur);
        if (!has_next) break;
#pragma unroll
        for (int a = 0; a < 2; ++a)
#pragma unroll
            for (int b = 0; b < 2; ++b)
#pragma unroll
                for (int m = 0; m < 4; ++m)
#pragma unroll
                    for (int n = 0; n < 2; ++n) acc[a][b][m][n] = (f32x4){0.f, 0.f, 0.f, 0.f};
        cur = nxt; cA = nA; cB = nB; ++ui;
        if constexpr (ALIGN_EPI) { if (wr == 1) PG8_BAR; }
    }
    PG8_WAIT_V(0);
    if constexpr (!ALIGN_EPI) { if (wr == 0) PG8_BAR; }
    PG8_BAR;
#undef PG8_SA
#undef PG8_SB
#undef PG8_STAGE
#undef PG8_LDA
#undef PG8_LDB
#undef PG8_MMA
#undef PG8_WAIT_V
#undef PG8_WAIT_L
#undef PG8_BAR
#undef PG8_SCHED
}
}

typedef const f32x4 (&AccRef)[2][2][4][2];

__device__ __forceinline__ void row_stats(const float* st, int r, float& mean, float& rstd) {
    const f32x2 s = *(const f32x2*)(st + 2 * (size_t)r);
    mean = s.x * (1.0f / DM); const float var = fmaxf(s.y * (1.0f / DM) - mean * mean, 0.f); rstd = rsqrtf(var + LN_EPS);
}

template <bool LN> struct EpiSwiglu {
    static constexpr bool PERM = true;
    bf16_t* O; const float* stats; const float* c1; const float* c2;
    __device__ __forceinline__ void operator()(AccRef acc, const pg8::Unit& u, int wr, int wc, int fr, int fq) const {
        const int row0 = u.pm * 256 + wr * 64 + fr, tc = wc * 32 + 8 * fq, bcol = u.pn * 256 + tc;
        f32x4 c1g[2], c1u[2], c2g[2], c2u[2];
        if (LN) {
#pragma unroll
            for (int n = 0; n < 2; ++n) { c1g[n] = *(const f32x4*)(c1 + bcol + 4 * n); c1u[n] = *(const f32x4*)(c1 + bcol + 128 + 4 * n); c2g[n] = *(const f32x4*)(c2 + bcol + 4 * n); c2u[n] = *(const f32x4*)(c2 + bcol + 128 + 4 * n); }
        }
#pragma unroll
        for (int ai = 0; ai < 2; ++ai)
#pragma unroll
            for (int m = 0; m < 4; ++m) {
                const int r = row0 + ai * 128 + m * 16; float mean = 0.f, rstd = 1.f;
                if (LN) row_stats(stats, r, mean, rstd);
                float o[8];
#pragma unroll
                for (int n = 0; n < 2; ++n)
#pragma unroll
                    for (int i = 0; i < 4; ++i) { float gv = acc[ai][0][m][n][i], uv = acc[ai][1][m][n][i];
                        if (LN) { gv = rstd * (gv - mean * c1g[n][i]) + c2g[n][i]; uv = rstd * (uv - mean * c1u[n][i]) + c2u[n][i]; }
                        o[4 * n + i] = gv * sigmoidf_(gv) * uv; }
                *(u32x4*)(O + (size_t)r * DFF + u.pn * 128 + tc) = pack8(o);
            }
    }
};

template <int MODE> struct EpiRes {
    static constexpr bool PERM = true;
    const float* xp; const float* xs; const bf16_t* zin; const float* stin; const float* gin; const float* bin; bf16_t* zout; float* stout;
    __device__ __forceinline__ void operator()(AccRef acc, const pg8::Unit& u, int wr, int wc, int fr, int fq) const {
        const int row0 = u.pm * 256 + wr * 64 + fr, col0 = u.pn * 256 + wc * 32 + 8 * fq;
        const float SC = (MODE == 1) ? 1.0f : 0.5f;
        f32x4 gv[2][2], bv[2][2];
        if (MODE != 0) {
#pragma unroll
            for (int bj = 0; bj < 2; ++bj)
#pragma unroll
                for (int n = 0; n < 2; ++n) { gv[bj][n] = *(const f32x4*)(gin + col0 + 128 * bj + 4 * n); bv[bj][n] = *(const f32x4*)(bin + col0 + 128 * bj + 4 * n); }
        }
#pragma unroll
        for (int ai = 0; ai < 2; ++ai)
#pragma unroll
            for (int m = 0; m < 4; ++m) {
                const int r = row0 + ai * 128 + m * 16; float mean = 0.f, rstd = 1.f;
                if (MODE != 0) row_stats(stin, r, mean, rstd);
                float s = 0.f, ss = 0.f;
#pragma unroll
                for (int bj = 0; bj < 2; ++bj) {
                    const int col = col0 + 128 * bj; float res[8];
                    if (MODE == 0) {
                        f32x4 a = (f32x4){0.f, 0.f, 0.f, 0.f}, b = a;
                        if (r < MPROMPT) { a = *(const f32x4*)(xp + (size_t)r * DM + col); b = *(const f32x4*)(xp + (size_t)r * DM + col + 4); }
                        else if (r < MTOT) { a = *(const f32x4*)(xs + (size_t)(r - MPROMPT) * DM + col); b = *(const f32x4*)(xs + (size_t)(r - MPROMPT) * DM + col + 4); }
#pragma unroll
                        for (int i = 0; i < 4; ++i) { res[i] = a[i]; res[4 + i] = b[i]; }
                    } else {
                        float zf[8]; unpack8(*(const u32x4*)(zin + (size_t)r * DM + col), zf);
#pragma unroll
                        for (int n = 0; n < 2; ++n)
#pragma unroll
                            for (int i = 0; i < 4; ++i) res[4 * n + i] = (zf[4 * n + i] - mean) * rstd * gv[bj][n][i] + bv[bj][n][i];
                    }
                    float o[8];
#pragma unroll
                    for (int n = 0; n < 2; ++n)
#pragma unroll
                        for (int i = 0; i < 4; ++i) { const float v = ALPHA * res[4 * n + i] + SC * acc[ai][bj][m][n][i]; o[4 * n + i] = v; s += v; ss += v * v; }
                    *(u32x4*)(zout + (size_t)r * DM + col) = pack8(o);
                }
                if (MODE != 2) {
                    s += __shfl_xor(s, 16); s += __shfl_xor(s, 32); ss += __shfl_xor(ss, 16); ss += __shfl_xor(ss, 32);
                    if (fq == 0) { atomicAdd(stout + 2 * (size_t)r, s); atomicAdd(stout + 2 * (size_t)r + 1, ss); }
                }
            }
    }
};

struct EpiProj {
    static constexpr bool PERM = true;
    bf16_t* P; const float* stats; const float* c1; const float* c2; const float* rope; float* out;
    __device__ __forceinline__ void operator()(AccRef acc, const pg8::Unit& u, int wr, int wc, int fr, int fq) const {
        const int pn = u.pn, row0 = u.pm * 256 + wr * 64 + fr, tc = wc * 32 + 8 * fq, bcol0 = pn * 256 + tc;
        f32x4 C1[2][2], C2[2][2];
#pragma unroll
        for (int bj = 0; bj < 2; ++bj)
#pragma unroll
            for (int n = 0; n < 2; ++n) { C1[bj][n] = *(const f32x4*)(c1 + bcol0 + 128 * bj + 4 * n); C2[bj][n] = *(const f32x4*)(c2 + bcol0 + 128 * bj + 4 * n); }
        const bool rot = (pn >= 3 && pn <= 6);
#pragma unroll
        for (int ai = 0; ai < 2; ++ai)
#pragma unroll
            for (int m = 0; m < 4; ++m) {
                const int r = row0 + ai * 128 + m * 16; float mean, rstd; row_stats(stats, r, mean, rstd);
                float v[2][8];
#pragma unroll
                for (int bj = 0; bj < 2; ++bj)
#pragma unroll
                    for (int n = 0; n < 2; ++n)
#pragma unroll
                        for (int i = 0; i < 4; ++i) v[bj][4 * n + i] = rstd * (acc[ai][bj][m][n][i] - mean * C1[bj][n][i]) + C2[bj][n][i];
                bf16_t* prow = P + (size_t)r * NPJ;
                if (rot) {
                    const int pidx = r < MPROMPT ? (r & (SEQ - 1)) : SEQ;
                    const int d0 = 32 * (wc & 1) + 8 * fq; const float* rp = rope + (size_t)pidx * 128 + d0;
                    const f32x4 ca = *(const f32x4*)rp, cb = *(const f32x4*)(rp + 4), sa = *(const f32x4*)(rp + 64), sb = *(const f32x4*)(rp + 68);
                    const float scl = (pn >= 5) ? 0.08838834764831845f : 1.0f;
                    float o1[8], o2[8];
#pragma unroll
                    for (int i = 0; i < 8; ++i) { const float c = i < 4 ? ca[i & 3] : cb[i & 3], s = i < 4 ? sa[i & 3] : sb[i & 3];
                        o1[i] = (v[0][i] * c - v[1][i] * s) * scl; o2[i] = (v[1][i] * c + v[0][i] * s) * scl; }
                    const int base = (pn >= 5 ? C_KR : C_QR) + (2 * ((pn - 3) & 1) + (wc >> 1)) * 128 + d0;
                    *(u32x4*)(prow + base) = pack8(o1); *(u32x4*)(prow + base + 64) = pack8(o2);
                } else {
                    if (pn >= 9) {
#pragma unroll
                        for (int bj = 0; bj < 2; ++bj)
#pragma unroll
                            for (int i = 0; i < 8; ++i) v[bj][i] = v[bj][i] * sigmoidf_(v[bj][i]);
                    }
#pragma unroll
                    for (int bj = 0; bj < 2; ++bj) *(u32x4*)(prow + pn * 256 + 128 * bj + tc) = pack8(v[bj]);
                    if (pn == 2) {
                        float* dst = nullptr;
                        if (r < MPROMPT) { const int p = r & (SEQ - 1); if (p >= SEQ - 128) dst = out + O_KWP + ((size_t)(r >> 11) * 128 + (p - (SEQ - 128))) * 128 + tc; }
                        else if (r < MTOT) dst = out + O_KWS + ((size_t)(r - MPROMPT) * 128 + 127) * 128 + tc;
                        if (dst) {
                            float* dv = dst + (r < MPROMPT ? (O_VWP - O_KWP) : (O_VWS - O_KWS));
                            *(f32x4*)dst = (f32x4){v[0][0], v[0][1], v[0][2], v[0][3]}; *(f32x4*)(dst + 4) = (f32x4){v[0][4], v[0][5], v[0][6], v[0][7]};
                            *(f32x4*)dv = (f32x4){v[1][0], v[1][1], v[1][2], v[1][3]}; *(f32x4*)(dv + 4) = (f32x4){v[1][4], v[1][5], v[1][6], v[1][7]};
                        }
                    }
                }
            }
    }
};

struct EpiGates {
    static constexpr bool PERM = true;
    bf16_t* GA; bf16_t* GB; const float* stats; const float* c1; const float* c2;
    __device__ __forceinline__ void operator()(AccRef acc, const pg8::Unit& u, int wr, int wc, int fr, int fq) const {
        const int pn = u.pn, row0 = u.pm * 256 + wr * 64 + fr, tc = wc * 32 + 8 * fq, bcol0 = pn * 256 + tc;
        bf16_t* G = (pn >= 4) ? GB : GA; const int gcol0 = (pn & 3) * 256 + tc;
        f32x4 C1[2][2], C2[2][2];
#pragma unroll
        for (int bj = 0; bj < 2; ++bj)
#pragma unroll
            for (int n = 0; n < 2; ++n) { C1[bj][n] = *(const f32x4*)(c1 + bcol0 + 128 * bj + 4 * n); C2[bj][n] = *(const f32x4*)(c2 + bcol0 + 128 * bj + 4 * n); }
#pragma unroll
        for (int ai = 0; ai < 2; ++ai)
#pragma unroll
            for (int m = 0; m < 4; ++m) {
                const int r = row0 + ai * 128 + m * 16; float mean, rstd; row_stats(stats, r, mean, rstd);
#pragma unroll
                for (int bj = 0; bj < 2; ++bj) { float o[8];
#pragma unroll
                    for (int n = 0; n < 2; ++n)
#pragma unroll
                        for (int i = 0; i < 4; ++i) o[4 * n + i] = sigmoidf_(rstd * (acc[ai][bj][m][n][i] - mean * C1[bj][n][i]) + C2[bj][n][i]);
                    *(u32x4*)(G + (size_t)r * DM + gcol0 + 128 * bj) = pack8(o); }
            }
    }
};

template <bool SECOND> struct EpiOut {
    static constexpr bool PERM = true;
    bf16_t* GA; bf16_t* GB;
    __device__ __forceinline__ void operator()(AccRef acc, const pg8::Unit& u, int wr, int wc, int fr, int fq) const {
        const int row0 = u.pm * 256 + wr * 64 + fr, col0 = u.pn * 256 + wc * 32 + 8 * fq;
#pragma unroll
        for (int ai = 0; ai < 2; ++ai)
#pragma unroll
            for (int m = 0; m < 4; ++m) {
                const int r = row0 + ai * 128 + m * 16;
#pragma unroll
                for (int bj = 0; bj < 2; ++bj) {
                    const size_t off = (size_t)r * DM + col0 + 128 * bj; float a[8], o[8];
                    unpack8(*(const u32x4*)(GA + off), a);
                    if (!SECOND) {
#pragma unroll
                        for (int n = 0; n < 2; ++n)
#pragma unroll
                            for (int i = 0; i < 4; ++i) o[4 * n + i] = a[4 * n + i] * acc[ai][bj][m][n][i];
                        *(u32x4*)(GA + off) = pack8(o);
                    } else {
                        float b[8]; unpack8(*(const u32x4*)(GB + off), b);
#pragma unroll
                        for (int n = 0; n < 2; ++n)
#pragma unroll
                            for (int i = 0; i < 4; ++i) o[4 * n + i] = a[4 * n + i] + b[4 * n + i] * acc[ai][bj][m][n][i];
                        *(u32x4*)(GB + off) = pack8(o);
                    }
                }
            }
    }
};

typedef short v4i16_t __attribute__((ext_vector_type(4)));
__device__ __forceinline__ unsigned offb(unsigned row, unsigned ch) { return 256u * row + 16u * (ch ^ (((row & 3u) << 2) | ((row >> 2) & 3u))); }
__device__ __forceinline__ bf16x8 lds_row_frag(LAS uchar* tile, int row, int ch) { return *(const LAS bf16x8*)(tile + offb((unsigned)row, (unsigned)ch)); }
__device__ __forceinline__ s16x4 lds_tr(LAS uchar* p) { return __builtin_bit_cast(s16x4, __builtin_amdgcn_ds_read_tr16_b64_v4i16((LAS v4i16_t*)p)); }
__device__ __forceinline__ bf16x8 lds_tr_frag(LAS uchar* tile, int rb0, int rb1, int c, int lane) {
    const unsigned q = (lane & 15) >> 2, p = lane & 3;
    const s16x4 lo = lds_tr(tile + offb((unsigned)rb0 + q, 2u * c + (p >> 1)) + 8u * (p & 1));
    const s16x4 hi = lds_tr(tile + offb((unsigned)rb1 + q, 2u * c + (p >> 1)) + 8u * (p & 1));
    return (bf16x8){lo[0], lo[1], lo[2], lo[3], hi[0], hi[1], hi[2], hi[3]};
}
__device__ __forceinline__ bf16x8 pack_frag(f32x4 a, f32x4 b) {
    u32x4 w; w.x = pk2(a[0], a[1]); w.y = pk2(a[2], a[3]); w.z = pk2(b[0], b[1]); w.w = pk2(b[2], b[3]); return __builtin_bit_cast(bf16x8, w);
}
#define MFMA16(a, b, c) __builtin_amdgcn_mfma_f32_16x16x32_bf16((a), (b), (c), 0, 0, 0)

constexpr int LDS_BTAB = 131072;
constexpr int LDS_BYTES = 131072 + 4096 + 1024;

__device__ __forceinline__ void attn_unit(LAS uchar* lds, bf16_t* P, const float* sinks, int b, int n, int kvh, int tid, int wid, int lane) {
    LAS uchar* KV = lds; LAS uchar* Q0 = lds + 65536; const LAS float* btab = (const LAS float*)(lds + LDS_BTAB);
#pragma unroll
    for (int i = 0; i < 8; ++i) { const int c = tid + 512 * i, row = c >> 4, ch = c & 15, kpos = 128 * (n - 1) + row;
        u32x4 v = (u32x4){0u, 0u, 0u, 0u};
        if (kpos >= 0) v = *(const u32x4*)(P + (size_t)(b * SEQ + kpos) * NPJ + (ch < 8 ? C_KA + 64 * kvh + 8 * ch : C_VA + 64 * kvh + 8 * (ch - 8)));
        *(LAS u32x4*)(KV + offb(row, ch)) = v; }
#pragma unroll
    for (int i = 0; i < 8; ++i) { const int c = tid + 512 * i, t = c >> 11, cc = c & 2047, row = cc >> 4, ch = cc & 15;
        *(LAS u32x4*)(Q0 + 32768 * t + offb(row, ch)) = *(const u32x4*)(P + (size_t)(b * SEQ + 128 * n + row) * NPJ + C_QA + 256 * kvh + 128 * t + 8 * ch); }
    __syncthreads();
    const int hq = wid >> 1, qh = wid & 1, h = 4 * kvh + hq, fr = lane & 15, g = lane >> 4;
    LAS uchar* Qt = Q0 + 32768 * (hq >> 1); const int qch0 = 8 * (hq & 1);
    const float sink = sinks[h];
    for (int it = 0; it < 4; ++it) {
        const int i0 = 64 * qh + 16 * it, jt0 = i0 >> 4;
        bf16x8 qf[2];
#pragma unroll
        for (int s = 0; s < 2; ++s) qf[s] = lds_row_frag(Qt, i0 + fr, qch0 + 4 * s + g);
        f32x4 sc[9];
#pragma unroll
        for (int t = 0; t < 9; ++t) { sc[t] = (f32x4){0.f, 0.f, 0.f, 0.f};
#pragma unroll
            for (int s = 0; s < 2; ++s) sc[t] = MFMA16(lds_row_frag(KV, 16 * (jt0 + t) + fr, 4 * s + g), qf[s], sc[t]); }
        float mx = -INFINITY;
#pragma unroll
        for (int t = 0; t < 9; ++t)
#pragma unroll
            for (int rg = 0; rg < 4; ++rg) {
                const int dist = 128 + fr - 16 * t - 4 * g - rg;
                bool ok = (dist >= 0) && (dist < 128); if (n == 0) ok = ok && (16 * (jt0 + t) + 4 * g + rg >= 128);
                const float v = ok ? sc[t][rg] * 0.125f + btab[h * 128 + (dist & 127)] : -INFINITY;
                sc[t][rg] = v; mx = fmaxf(mx, v);
            }
        mx = fmaxf(mx, __shfl_xor(mx, 16)); mx = fmaxf(mx, __shfl_xor(mx, 32));
        const float mm = fmaxf(mx, sink);
        float sum = 0.f;
#pragma unroll
        for (int t = 0; t < 9; ++t)
#pragma unroll
            for (int rg = 0; rg < 4; ++rg) { const float p = __expf(sc[t][rg] - mm); sc[t][rg] = p; sum += p; }
        sum += __shfl_xor(sum, 16); sum += __shfl_xor(sum, 32);
        const float rinv = 1.0f / (sum + __expf(sink - mm));
        f32x4 o[4];
#pragma unroll
        for (int et = 0; et < 4; ++et) o[et] = (f32x4){0.f, 0.f, 0.f, 0.f};
#pragma unroll
        for (int kk = 0; kk < 5; ++kk) {
            const int t0 = 2 * kk, t1 = 2 * kk + 1;
            const bf16x8 pf = pack_frag(sc[t0], t1 < 9 ? sc[t1 < 9 ? t1 : 8] : (f32x4){0.f, 0.f, 0.f, 0.f});
            const int r0 = 16 * (jt0 + t0) + 4 * g, r1 = t1 < 9 ? 16 * (jt0 + t1) + 4 * g : r0;
#pragma unroll
            for (int et = 0; et < 4; ++et) o[et] = MFMA16(lds_tr_frag(KV, r0, r1, 4 + et, lane), pf, o[et]);
        }
        bf16_t* orow = P + (size_t)(b * SEQ + 128 * n + i0 + fr) * NPJ + C_QA + 64 * h + 4 * g;
#pragma unroll
        for (int et = 0; et < 4; ++et) { u32x2 w; w.x = pk2(o[et][0] * rinv, o[et][1] * rinv); w.y = pk2(o[et][2] * rinv, o[et][3] * rinv); *(u32x2*)(orow + 16 * et) = w; }
    }
    __syncthreads();
}

__device__ __forceinline__ float ret_lg(int h) { return log1pf(-exp2f(-5.0f - (float)h)); }

__device__ __forceinline__ void retu_unit(LAS uchar* lds, const bf16_t* P, float* U, int b, int h, int n, int tid, int wid, int lane) {
    LAS uchar* Kt = lds; LAS uchar* Vt = lds + 32768;
    const float lg = ret_lg(h);
#pragma unroll
    for (int i = 0; i < 4; ++i) { const int c = tid + 512 * i, row = c >> 4, ch = c & 15; const bf16_t* src = P + (size_t)(b * SEQ + 128 * n + row) * NPJ + 128 * h + 8 * ch;
        float kf[8]; unpack8(*(const u32x4*)(src + C_KR), kf); const float scl = __expf((float)(127 - row) * lg);
#pragma unroll
        for (int j = 0; j < 8; ++j) kf[j] *= scl;
        *(LAS u32x4*)(Kt + offb(row, ch)) = pack8(kf);
        *(LAS u32x4*)(Vt + offb(row, ch)) = *(const u32x4*)(src + C_VR); }
    __syncthreads();
    const int fr = lane & 15, g = lane >> 4;
    f32x4 acc[8];
#pragma unroll
    for (int et = 0; et < 8; ++et) acc[et] = (f32x4){0.f, 0.f, 0.f, 0.f};
#pragma unroll
    for (int ks = 0; ks < 4; ++ks) {
        const bf16x8 kfr = lds_tr_frag(Kt, 32 * ks + 8 * g, 32 * ks + 8 * g + 4, wid, lane);
#pragma unroll
        for (int et = 0; et < 8; ++et) acc[et] = MFMA16(lds_tr_frag(Vt, 32 * ks + 8 * g, 32 * ks + 8 * g + 4, et, lane), kfr, acc[et]);
    }
    float* Uu = U + ((size_t)((b * 4 + h) * 16 + n)) * 16384 + (size_t)(16 * wid + fr) * 128 + 4 * g;
#pragma unroll
    for (int et = 0; et < 8; ++et) *(f32x4*)(Uu + 16 * et) = acc[et];
    __syncthreads();
}

__device__ __forceinline__ void reto_unit(LAS uchar* lds, bf16_t* P, const float* U, float* state_out, int b, int h, int n, int tid, int wid, int lane) {
    LAS uchar* Qt = lds; LAS uchar* Kt = lds + 32768; LAS uchar* Vt = lds + 65536; LAS uchar* St = lds + 98304;
    const float lg = ret_lg(h), decay = __expf(128.0f * lg);
#pragma unroll
    for (int i = 0; i < 4; ++i) { const int c = tid + 512 * i, row = c >> 4, ch = c & 15; const bf16_t* src = P + (size_t)(b * SEQ + 128 * n + row) * NPJ + 128 * h + 8 * ch;
        *(LAS u32x4*)(Qt + offb(row, ch)) = *(const u32x4*)(src + C_QR);
        *(LAS u32x4*)(Kt + offb(row, ch)) = *(const u32x4*)(src + C_KR);
        *(LAS u32x4*)(Vt + offb(row, ch)) = *(const u32x4*)(src + C_VR); }
    const float* Ub = U + (size_t)((b * 4 + h) * 16) * 16384;
    for (int i = 0; i < 8; ++i) { const int e4 = tid + 512 * i; f32x4 s = (f32x4){0.f, 0.f, 0.f, 0.f};
        for (int m = 0; m < n; ++m) s = s * decay + *(const f32x4*)(Ub + (size_t)m * 16384 + 4 * e4);
        if (n == 15) { const f32x4 fin = s * decay + *(const f32x4*)(Ub + (size_t)15 * 16384 + 4 * e4); *(f32x4*)(state_out + (size_t)(b * 4 + h) * 16384 + 4 * e4) = fin; }
        const int d = e4 >> 5, e = (e4 & 31) * 4; u32x2 w; w.x = pk2(s[0], s[1]); w.y = pk2(s[2], s[3]);
        *(LAS u32x2*)(St + offb(d, e >> 3) + (e & 7) * 2) = w; }
    __syncthreads();
    const int fr = lane & 15, g = lane >> 4, i0 = 16 * wid;
    bf16x8 qf[4];
#pragma unroll
    for (int s = 0; s < 4; ++s) qf[s] = lds_row_frag(Qt, i0 + fr, 4 * s + g);
    f32x4 acc[8];
#pragma unroll
    for (int et = 0; et < 8; ++et) acc[et] = (f32x4){0.f, 0.f, 0.f, 0.f};
    if (n > 0) {
#pragma unroll
        for (int s = 0; s < 4; ++s)
#pragma unroll
            for (int et = 0; et < 8; ++et) acc[et] = MFMA16(lds_tr_frag(St, 32 * s + 8 * g, 32 * s + 8 * g + 4, et, lane), qf[s], acc[et]);
        const float gi = __expf((float)(i0 + fr + 1) * lg);
#pragma unroll
        for (int et = 0; et < 8; ++et) acc[et] = acc[et] * gi;
    }
    for (int kk = 0; 2 * kk <= wid; ++kk) {
        const int t0 = 2 * kk, t1 = 2 * kk + 1; const bool has1 = t1 <= wid;
        f32x4 p0 = (f32x4){0.f, 0.f, 0.f, 0.f}, p1 = p0;
#pragma unroll
        for (int s = 0; s < 4; ++s) p0 = MFMA16(lds_row_frag(Kt, 16 * t0 + fr, 4 * s + g), qf[s], p0);
        if (has1) {
#pragma unroll
            for (int s = 0; s < 4; ++s) p1 = MFMA16(lds_row_frag(Kt, 16 * t1 + fr, 4 * s + g), qf[s], p1);
        }
#pragma unroll
        for (int rg = 0; rg < 4; ++rg) {
            const int d0 = 16 * (wid - t0) + fr - 4 * g - rg, d1 = d0 - 16;
            p0[rg] = d0 >= 0 ? p0[rg] * __expf((float)d0 * lg) : 0.f;
            p1[rg] = (has1 && d1 >= 0) ? p1[rg] * __expf((float)d1 * lg) : 0.f;
        }
        const bf16x8 pf = pack_frag(p0, p1);
        const int r0 = 16 * t0 + 4 * g, r1 = has1 ? 16 * t1 + 4 * g : r0;
#pragma unroll
        for (int et = 0; et < 8; ++et) acc[et] = MFMA16(lds_tr_frag(Vt, r0, r1, et, lane), pf, acc[et]);
    }
    float s = 0.f;
#pragma unroll
    for (int et = 0; et < 8; ++et) s += (acc[et][0] + acc[et][1]) + (acc[et][2] + acc[et][3]);
    s += __shfl_xor(s, 16); s += __shfl_xor(s, 32);
    const float mu = s * (1.0f / 128.0f); float q = 0.f;
#pragma unroll
    for (int et = 0; et < 8; ++et) { const f32x4 d = acc[et] - mu; q += (d[0] * d[0] + d[1] * d[1]) + (d[2] * d[2] + d[3] * d[3]); }
    q += __shfl_xor(q, 16); q += __shfl_xor(q, 32);
    const float rstd = rsqrtf(q * (1.0f / 128.0f) + GN_EPS);
    bf16_t* prow = P + (size_t)(b * SEQ + 128 * n + i0 + fr) * NPJ + 128 * h + 4 * g;
#pragma unroll
    for (int et = 0; et < 8; ++et) { const u32x2 gw = *(const u32x2*)(prow + C_GR + 16 * et);
        u32x2 w; w.x = pk2((acc[et][0] - mu) * rstd * bflo(gw.x), (acc[et][1] - mu) * rstd * bfhi(gw.x)); w.y = pk2((acc[et][2] - mu) * rstd * bflo(gw.y), (acc[et][3] - mu) * rstd * bfhi(gw.y));
        *(u32x2*)(prow + C_QR + 16 * et) = w; }
    __syncthreads();
}

__device__ __forceinline__ float wave_sum(float v) {
#pragma unroll
    for (int o = 1; o < 64; o <<= 1) v += __shfl_xor(v, o);
    return v;
}
__device__ __forceinline__ float wave_max(float v) {
#pragma unroll
    for (int o = 1; o < 64; o <<= 1) v = fmaxf(v, __shfl_xor(v, o));
    return v;
}
__device__ __forceinline__ void sample_unit(LAS uchar* lds, bf16_t* P, const float* ck, const float* cv, const float* st_in, float* out, const float* sinks, int s, int tid, int wid, int lane) {
    LAS float* KT = (LAS float*)lds;
    LAS float* pbuf = (LAS float*)(lds + 67584);
    LAS float* qa = (LAS float*)(lds + 71680);
    LAS float* qr = (LAS float*)(lds + 73728);
    LAS float* kr = (LAS float*)(lds + 75776);
    LAS float* red = (LAS float*)(lds + 77824);
    const LAS float* btab = (const LAS float*)(lds + LDS_BTAB);
    bf16_t* Pr = P + (size_t)(MPROMPT + s) * NPJ;
    float* kwin = out + O_KWS + (size_t)s * 16384; float* vwin = out + O_VWS + (size_t)s * 16384;
#pragma unroll
    for (int i = 0; i < 8; ++i) { const int c = tid + 512 * i, j = c >> 5, q4 = c & 31; f32x4 v;
        if (j < 127) { v = *(const f32x4*)(ck + ((size_t)s * 128 + j + 1) * 128 + 4 * q4); *(f32x4*)(kwin + j * 128 + 4 * q4) = v; }
        else { const u32x2 w = *(const u32x2*)(Pr + C_KA + 4 * q4); v = (f32x4){bflo(w.x), bfhi(w.x), bflo(w.y), bfhi(w.y)}; }
        *(LAS f32x4*)(KT + j * 132 + 4 * q4) = v; }
    qa[tid] = bf2f(Pr[C_QA + tid]);
    __syncthreads();
    const int h = wid, kvh = h >> 2; const float sink = sinks[h];
    float v2[2];
#pragma unroll
    for (int jj = 0; jj < 2; ++jj) { const int j = lane + 64 * jj; float a = 0.f;
#pragma unroll
        for (int d4 = 0; d4 < 16; ++d4) { const f32x4 kx = *(const LAS f32x4*)(KT + j * 132 + 64 * kvh + 4 * d4), qx = *(const LAS f32x4*)(qa + 64 * h + 4 * d4);
            a += (kx[0] * qx[0] + kx[1] * qx[1]) + (kx[2] * qx[2] + kx[3] * qx[3]); }
        v2[jj] = a * 0.125f + btab[h * 128 + (127 - j)]; }
    const float mm = fmaxf(wave_max(fmaxf(v2[0], v2[1])), sink);
    const float p0 = __expf(v2[0] - mm), p1 = __expf(v2[1] - mm);
    const float rinv = 1.0f / (wave_sum(p0 + p1) + __expf(sink - mm));
    pbuf[h * 128 + lane] = p0; pbuf[h * 128 + 64 + lane] = p1;
    __syncthreads();
#pragma unroll
    for (int i = 0; i < 8; ++i) { const int c = tid + 512 * i, j = c >> 5, q4 = c & 31; f32x4 v;
        if (j < 127) { v = *(const f32x4*)(cv + ((size_t)s * 128 + j + 1) * 128 + 4 * q4); *(f32x4*)(vwin + j * 128 + 4 * q4) = v; }
        else { const u32x2 w = *(const u32x2*)(Pr + C_VA + 4 * q4); v = (f32x4){bflo(w.x), bfhi(w.x), bflo(w.y), bfhi(w.y)}; }
        *(LAS f32x4*)(KT + j * 132 + 4 * q4) = v; }
    qr[tid] = bf2f(Pr[C_QR + tid]); kr[tid] = bf2f(Pr[C_KR + tid]);
    const float v_e = bf2f(Pr[C_VR + tid]), sg = bf2f(Pr[C_GR + tid]);
    __syncthreads();
    { float a = 0.f;
#pragma unroll 8
      for (int j = 0; j < 128; ++j) a += pbuf[h * 128 + j] * KT[j * 132 + 64 * kvh + lane];
      Pr[C_QA + 64 * h + lane] = (bf16_t)f2bf(a * rinv); }
    const int hr = tid >> 7, e = tid & 127; const float lg = ret_lg(hr), gamma = __expf(lg);
    const float* S = st_in + ((size_t)(s * 4 + hr) * 128) * 128 + e; float* So = out + O_SS + ((size_t)(s * 4 + hr) * 128) * 128 + e;
    float o = 0.f, qk = 0.f;
#pragma unroll 8
    for (int d = 0; d < 128; ++d) { const float qd = qr[128 * hr + d], kd = kr[128 * hr + d], sv = S[(size_t)d * 128]; o += qd * sv; qk += qd * kd; So[(size_t)d * 128] = gamma * sv + kd * v_e; }
    o = gamma * o + qk * v_e;
    const float ws = wave_sum(o); if (lane == 0) red[wid] = ws;
    __syncthreads();
    const float mu = (red[2 * hr] + red[2 * hr + 1]) * (1.0f / 128.0f); const float dv = o - mu;
    const float wq = wave_sum(dv * dv); if (lane == 0) red[8 + wid] = wq;
    __syncthreads();
    const float rstd = rsqrtf((red[8 + 2 * hr] + red[8 + 2 * hr + 1]) * (1.0f / 128.0f) + GN_EPS);
    Pr[C_QR + tid] = (bf16_t)f2bf(dv * rstd * sg);
    __syncthreads();
}

__device__ __forceinline__ int map_up(int c) { const int isup = c >= DFF ? 1 : 0; const int cc = isup ? c - DFF : c; return ((cc >> 7) << 8) + (isup << 7) + (cc & 127); }
__device__ __forceinline__ int map_in(int c) {
    if (c >= C_QR && c < C_VR) { const int iskr = c >= C_KR ? 1 : 0; const int cc = c - (iskr ? C_KR : C_QR); const int head = cc >> 7, half = (cc >> 6) & 1, d = cc & 63;
        return ((iskr ? 5 : 3) + (head >> 1)) * 256 + half * 128 + (head & 1) * 64 + d; }
    return c;
}
template <int MAP, bool LN>
__device__ __forceinline__ void p0_transpose_item(const float* W, int K, int N, bf16_t* WT, const float* g, const float* bvec, float* c1, float* c2, LAS float* scr, int item, int lane) {
    const int nblk = N / 32, kb = item / nblk, nb = item % nblk, k0 = 64 * kb, n0 = 32 * nb;
    float s1 = 0.f, s2 = 0.f;
#pragma unroll 8
    for (int i = 0; i < 32; ++i) { const int kk = 2 * i + (lane >> 5); float w = W[(size_t)(k0 + kk) * N + n0 + (lane & 31)];
        if (LN) { const float wg = w * g[k0 + kk]; s2 += bvec[k0 + kk] * w; w = __uint_as_float(f2bf(wg) << 16); s1 += w; }
        scr[kk * 33 + (lane & 31)] = w; }
    if (LN) { s1 += __shfl_xor(s1, 32); s2 += __shfl_xor(s2, 32);
        if (lane < 32) { const int src = n0 + lane; const int dr = MAP == 1 ? map_up(src) : (MAP == 2 ? map_in(src) : src); atomicAdd(c1 + dr, s1); atomicAdd(c2 + dr, s2); } }
    asm volatile("s_waitcnt lgkmcnt(0)" ::: "memory");
    const int c = lane & 7;
#pragma unroll
    for (int j = 0; j < 4; ++j) { const int n = (lane >> 3) + 8 * j; const LAS float* sp = scr + (8 * c) * 33 + n;
        u32x4 o; o.x = pk2(sp[0 * 33], sp[1 * 33]); o.y = pk2(sp[2 * 33], sp[3 * 33]); o.z = pk2(sp[4 * 33], sp[5 * 33]); o.w = pk2(sp[6 * 33], sp[7 * 33]);
        const int src = n0 + n; const int dr = MAP == 1 ? map_up(src) : (MAP == 2 ? map_in(src) : src);
        *(u32x4*)(WT + (size_t)dr * K + k0 + 8 * c) = o; }
    asm volatile("s_waitcnt lgkmcnt(0)" ::: "memory");
}

struct Args { const float* in[21]; float* out; unsigned char* ws; int ph_lo, ph_hi; };
constexpr int N_PHASES = 13;

template <bool COOP>
__global__ void __launch_bounds__(512, 2) fwd_kernel(Args args) {
    extern __shared__ __attribute__((aligned(16))) unsigned char lds_raw[];
    LAS uchar* lds = (LAS uchar*)lds_raw;
    const int tid = threadIdx.x, lane = tid & 63, wid = __builtin_amdgcn_readfirstlane(tid >> 6);
    const int G = gridDim.x, bx = blockIdx.x;
    unsigned char* ws = args.ws; float* out = args.out;
    const float* x_prompt = args.in[0]; const float* x_sample = args.in[1]; const float* cache_k = args.in[2]; const float* cache_v = args.in[3]; const float* state_in = args.in[4];
    const float* rel_bias = args.in[5]; const float* w_in = args.in[6]; const float* sinks = args.in[7]; const float* w_ao = args.in[8]; const float* w_ro = args.in[9]; const float* w_o = args.in[10];
    const float* w_up1 = args.in[11]; const float* w_dn1 = args.in[12]; const float* w_up2 = args.in[13]; const float* w_dn2 = args.in[14];
    const float* ln1_g = args.in[15]; const float* ln1_b = args.in[16]; const float* ln2_g = args.in[17]; const float* ln2_b = args.in[18]; const float* ln3_g = args.in[19]; const float* ln3_b = args.in[20];
    float* st1 = (float*)(ws + CTL_ST1); float* st2 = (float*)(ws + CTL_ST2);
    float* c1in = (float*)(ws + CTL_C1IN); float* c2in = (float*)(ws + CTL_C2IN); float* c1up = (float*)(ws + CTL_C1UP); float* c2up = (float*)(ws + CTL_C2UP);
    float* rope = (float*)(ws + WS_ROPE);
    bf16_t* Wup1 = (bf16_t*)(ws + WS_WUP1); bf16_t* Wdn1 = (bf16_t*)(ws + WS_WDN1); bf16_t* Win = (bf16_t*)(ws + WS_WIN); bf16_t* Wao = (bf16_t*)(ws + WS_WAO); bf16_t* Wro = (bf16_t*)(ws + WS_WRO);
    bf16_t* Wo = (bf16_t*)(ws + WS_WO); bf16_t* Wup2 = (bf16_t*)(ws + WS_WUP2); bf16_t* Wdn2 = (bf16_t*)(ws + WS_WDN2);
    bf16_t* XB = (bf16_t*)(ws + WS_XB); bf16_t* Z1 = (bf16_t*)(ws + WS_Z1); bf16_t* Z2 = (bf16_t*)(ws + WS_Z2); bf16_t* BIG = (bf16_t*)(ws + WS_BIG);
    bf16_t* GA = XB; bf16_t* GB = (bf16_t*)((unsigned char*)out + OUT_GB); float* U = (float*)((unsigned char*)out + OUT_U);

    const int lo = args.ph_lo, hi = args.ph_hi;
#define IN(k) (lo <= (k) && (k) < hi)
#define SEAM(k) do { if (IN(k) && IN((k) + 1)) { if constexpr (COOP) { cg::this_grid().sync(); } } } while (0)
    const int gw = bx * 8 + wid, NGW = G * 8;

    if (IN(0)) {
        LAS float* scr = (LAS float*)(lds + wid * 16384);
        constexpr int I_UP = (DM / 64) * (NUP / 32), I_DN = (DFF / 64) * (DM / 32), I_IN = (DM / 64) * (NIN / 32), I_AO = (512 / 64) * (DM / 32), I_O = (DM / 64) * (DM / 32);
        constexpr int NITEMS = 2 * I_UP + 2 * I_DN + I_IN + 2 * I_AO + I_O;
        for (int it = gw; it < NITEMS; it += NGW) {
            int r = it;
            if (r < I_UP) { p0_transpose_item<1, false>(w_up1, DM, NUP, Wup1, nullptr, nullptr, nullptr, nullptr, scr, r, lane); continue; } r -= I_UP;
            if (r < I_UP) { p0_transpose_item<1, true>(w_up2, DM, NUP, Wup2, ln2_g, ln2_b, c1up, c2up, scr, r, lane); continue; } r -= I_UP;
            if (r < I_DN) { p0_transpose_item<0, false>(w_dn1, DFF, DM, Wdn1, nullptr, nullptr, nullptr, nullptr, scr, r, lane); continue; } r -= I_DN;
            if (r < I_DN) { p0_transpose_item<0, false>(w_dn2, DFF, DM, Wdn2, nullptr, nullptr, nullptr, nullptr, scr, r, lane); continue; } r -= I_DN;
            if (r < I_IN) { p0_transpose_item<2, true>(w_in, DM, NIN, Win, ln1_g, ln1_b, c1in, c2in, scr, r, lane); continue; } r -= I_IN;
            if (r < I_AO) { p0_transpose_item<0, false>(w_ao, 512, DM, Wao, nullptr, nullptr, nullptr, nullptr, scr, r, lane); continue; } r -= I_AO;
            if (r < I_AO) { p0_transpose_item<0, false>(w_ro, 512, DM, Wro, nullptr, nullptr, nullptr, nullptr, scr, r, lane); continue; } r -= I_AO;
            p0_transpose_item<0, false>(w_o, DM, DM, Wo, nullptr, nullptr, nullptr, nullptr, scr, r, lane);
        }
        for (int m = gw; m < MPAD; m += NGW) {
            const float* src = m < MPROMPT ? x_prompt + (size_t)m * DM : (m < MTOT ? x_sample + (size_t)(m - MPROMPT) * DM : nullptr);
#pragma unroll
            for (int j = 0; j < 2; ++j) { const int col = 512 * j + 8 * lane; u32x4 w = (u32x4){0u, 0u, 0u, 0u};
                if (src) { const f32x4 a = *(const f32x4*)(src + col), b = *(const f32x4*)(src + col + 4); w.x = pk2(a[0], a[1]); w.y = pk2(a[2], a[3]); w.z = pk2(b[0], b[1]); w.w = pk2(b[2], b[3]); }
                *(u32x4*)(XB + (size_t)m * DM + col) = w; }
        }
        for (int e = bx * 512 + tid; e < 2049 * 64; e += G * 512) {
            const int p = e >> 6, d = e & 63; const int pos = p < SEQ ? p : 16384;
            const float inv = (float)pow(10000.0, -(double)d / 64.0); const float ang = (float)pos * inv;
            rope[(size_t)p * 128 + d] = (float)cos((double)ang); rope[(size_t)p * 128 + 64 + d] = (float)sin((double)ang);
        }
    }
    SEAM(0);
    if (IN(1)) {
        pg8::Gemm g{XB, Wup1, MPAD, NUP, DM, DM}; pg8::StaticOrder S; S.init(MPAD, NUP, G, bx);
        EpiSwiglu<false> E{BIG, nullptr, nullptr, nullptr};
        pg8::gemm_phase<EpiSwiglu<false>, pg8::StaticOrder, true, true>(lds, g, S, E);
    }
    SEAM(1);
    if (IN(2)) {
        pg8::Gemm g{BIG, Wdn1, MPAD, DM, DFF, DFF}; pg8::StaticOrder S; S.init(MPAD, DM, G, bx);
        EpiRes<0> E{x_prompt, x_sample, nullptr, nullptr, nullptr, nullptr, Z1, st1};
        pg8::gemm_phase<EpiRes<0>, pg8::StaticOrder, true, true>(lds, g, S, E);
    }
    SEAM(2);
    if (IN(3)) {
        pg8::Gemm g{Z1, Win, MPAD, NPJ, DM, DM}; pg8::StaticOrder S; S.init(MPAD, NPJ, G, bx);
        EpiProj E{BIG, st1, c1in, c2in, rope, out};
        pg8::gemm_phase<EpiProj, pg8::StaticOrder, true, true>(lds, g, S, E);
    }
    SEAM(3);
    if (IN(4)) {
        LAS float* btab = (LAS float*)(lds + LDS_BTAB);
        for (int i = tid; i < 1024; i += 512) { const int h = i >> 7, n = i & 127; int bucket = n;
            if (n >= 16) { const float v = logf((float)n / 16.0f) / 2.0794415416798357f * 16.0f; bucket = 16 + (int)v; if (bucket > 31) bucket = 31; }
            btab[i] = rel_bias[bucket * 8 + h]; }
        __syncthreads();
        for (int L = bx; L < 128 + 256 + 512; L += G) {
            if (L < 128) sample_unit(lds, BIG, cache_k, cache_v, state_in, out, sinks, L, tid, wid, lane);
            else if (L < 384) { const int a = L - 128; attn_unit(lds, BIG, sinks, a >> 5, (a >> 1) & 15, a & 1, tid, wid, lane); }
            else { const int a = L - 384; retu_unit(lds, BIG, U, a >> 6, (a >> 4) & 3, a & 15, tid, wid, lane); }
        }
    }
    SEAM(4);
    if (IN(5)) {
        for (int L = bx; L < 512; L += G) { const int a = L < 256 ? L : 256 + ((L - 256) ^ 15); reto_unit(lds, BIG, U, out + O_SP, a >> 6, (a >> 4) & 3, a & 15, tid, wid, lane); }
    }
    SEAM(5);
    if (IN(6)) {
        pg8::Gemm g{Z1, Win + (size_t)NPJ * DM, MPAD, NGT, DM, DM}; pg8::StaticOrder S; S.init(MPAD, NGT, G, bx);
        EpiGates E{GA, GB, st1, c1in + NPJ, c2in + NPJ};
        pg8::gemm_phase<EpiGates, pg8::StaticOrder, true, true>(lds, g, S, E);
    }
    SEAM(6);
    if (IN(7)) {
        pg8::Gemm g{BIG + C_QA, Wao, MPAD, DM, 512, NPJ}; pg8::StaticOrder S; S.init(MPAD, DM, G, bx);
        EpiOut<false> E{GA, GB};
        pg8::gemm_phase<EpiOut<false>, pg8::StaticOrder, true, true>(lds, g, S, E);
    }
    SEAM(7);
    if (IN(8)) {
        pg8::Gemm g{BIG + C_QR, Wro, MPAD, DM, 512, NPJ}; pg8::StaticOrder S; S.init(MPAD, DM, G, bx);
        EpiOut<true> E{GA, GB};
        pg8::gemm_phase<EpiOut<true>, pg8::StaticOrder, true, true>(lds, g, S, E);
    }
    SEAM(8);
    if (IN(9)) {
        pg8::Gemm g{GB, Wo, MPAD, DM, DM, DM}; pg8::StaticOrder S; S.init(MPAD, DM, G, bx);
        EpiRes<1> E{nullptr, nullptr, Z1, st1, ln1_g, ln1_b, Z2, st2};
        pg8::gemm_phase<EpiRes<1>, pg8::StaticOrder, true, true>(lds, g, S, E);
    }
    SEAM(9);
    if (IN(10)) {
        pg8::Gemm g{Z2, Wup2, MPAD, NUP, DM, DM}; pg8::StaticOrder S; S.init(MPAD, NUP, G, bx);
        EpiSwiglu<true> E{BIG, st2, c1up, c2up};
        pg8::gemm_phase<EpiSwiglu<true>, pg8::StaticOrder, true, true>(lds, g, S, E);
    }
    SEAM(10);
    if (IN(11)) {
        pg8::Gemm g{BIG, Wdn2, MPAD, DM, DFF, DFF}; pg8::StaticOrder S; S.init(MPAD, DM, G, bx);
        EpiRes<2> E{nullptr, nullptr, Z2, st2, ln2_g, ln2_b, Z1, nullptr};
        pg8::gemm_phase<EpiRes<2>, pg8::StaticOrder, true, true>(lds, g, S, E);
    }
    SEAM(11);
    if (IN(12)) {
        for (int m = gw; m < MTOT; m += NGW) {
            const bf16_t* zr = Z1 + (size_t)m * DM; float v[16];
            { float a[8]; unpack8(*(const u32x4*)(zr + 8 * lane), a);
#pragma unroll
              for (int i = 0; i < 8; ++i) v[i] = a[i];
              unpack8(*(const u32x4*)(zr + 512 + 8 * lane), a);
#pragma unroll
              for (int i = 0; i < 8; ++i) v[8 + i] = a[i]; }
            float s = 0.f;
#pragma unroll
            for (int i = 0; i < 16; ++i) s += v[i];
            const float mean = wave_sum(s) * (1.0f / DM); float q = 0.f;
#pragma unroll
            for (int i = 0; i < 16; ++i) { v[i] -= mean; q += v[i] * v[i]; }
            const float rstd = rsqrtf(wave_sum(q) * (1.0f / DM) + LN_EPS);
            float* orow = m < MPROMPT ? out + O_YP + (size_t)m * DM : out + O_YS + (size_t)(m - MPROMPT) * DM;
#pragma unroll
            for (int j = 0; j < 2; ++j)
#pragma unroll
                for (int k = 0; k < 2; ++k) { const int col = 512 * j + 8 * lane + 4 * k; const f32x4 gg = *(const f32x4*)(ln3_g + col), bb = *(const f32x4*)(ln3_b + col); f32x4 o;
#pragma unroll
                    for (int i = 0; i < 4; ++i) o[i] = v[8 * j + 4 * k + i] * rstd * gg[i] + bb[i];
                    *(f32x4*)(orow + col) = o; }
        }
    }
#undef IN
#undef SEAM
}

extern "C" void kernel_launch(void* const* d_in, const int* in_sizes, int n_in, void* d_out, int out_size, void* d_ws, size_t ws_size, hipStream_t stream) {
    static int grid = 0;
    constexpr bool COOP = (MK_N_LAUNCHES == 1);
    auto kfn = fwd_kernel<COOP>;
    if (grid == 0) {
        if (n_in != 21 || ws_size < WS_END) { fprintf(stderr, "kernel_launch: unexpected inputs (n_in %d, ws %zu)\n", n_in, ws_size); grid = -1; return; }
        int dev = 0, cus = 0, per_cu = 0;
        if (hipGetDevice(&dev) != hipSuccess || hipDeviceGetAttribute(&cus, hipDeviceAttributeMultiprocessorCount, dev) != hipSuccess) { grid = -1; return; }
        if (hipFuncSetAttribute((const void*)kfn, hipFuncAttributeMaxDynamicSharedMemorySize, LDS_BYTES) != hipSuccess) { fprintf(stderr, "kernel_launch: hipFuncSetAttribute failed\n"); grid = -1; return; }
        if (hipOccupancyMaxActiveBlocksPerMultiprocessor(&per_cu, (const void*)kfn, 512, LDS_BYTES) != hipSuccess || per_cu < 1) { fprintf(stderr, "kernel_launch: occupancy query says %d\n", per_cu); per_cu = 1; }
        (void)hipGetLastError();
        grid = cus;
    }
    if (grid < 0) return;
    (void)hipMemsetAsync((char*)d_ws + WS_CTL, 0, CTL_BYTES, stream);
    Args a{};
    for (int i = 0; i < 21; ++i) a.in[i] = (const float*)d_in[i];
    a.out = (float*)d_out; a.ws = (unsigned char*)d_ws;
    if (COOP) {
        a.ph_lo = 0; a.ph_hi = N_PHASES;
        void* params[] = {&a};
        hipError_t e = hipLaunchCooperativeKernel((const void*)kfn, dim3(grid), dim3(512), params, LDS_BYTES, stream);
        if (e != hipSuccess) fprintf(stderr, "cooperative launch failed: %s (grid %d)\n", hipGetErrorString(e), grid);
    } else {
        for (int p = 0; p < N_PHASES; ++p) {
            a.ph_lo = p; a.ph_hi = p + 1;
            hipLaunchKernelGGL(kfn, dim3(grid), dim3(512), LDS_BYTES, stream, a);
        }
    }
}
```
